# Optimizing an MI355X kernel written in HIP

```python
import jax, jax.numpy as jnp
from jax import lax
import numpy as np

D_MODEL = 1024
BATCH = 4
SEQ = 4096
DEPTH = 1

EPS = 1e-6
SGU_CHUNK = 128
SGU_GROUPS = 8
SGU_WIDTH = D_MODEL
SGU_GROUP_DIM = SGU_WIDTH // SGU_GROUPS
GLA_HEADS = 4
GLA_DK = D_MODEL // 2
GLA_DV = D_MODEL
GLA_HEAD_DK = GLA_DK // GLA_HEADS
GLA_HEAD_DV = GLA_DV // GLA_HEADS
GLA_LOWRANK = 16
GLA_GATE_NORMALIZER = 16.0
GLA_CHUNK = 64
D_FF = -(-(8 * D_MODEL) // (3 * 256)) * 256
IN_SIZES = (SGU_WIDTH, SGU_WIDTH, GLA_DK, GLA_DK, GLA_DV, GLA_DV, GLA_LOWRANK, D_MODEL, D_MODEL)
IN_COLS = 2 * SGU_WIDTH + 2 * GLA_DK + 2 * GLA_DV + GLA_LOWRANK + 2 * D_MODEL

kernel_name = "hybrid_gmlp_gla_gated_merge"


def rms_norm(x, w):
    xf = x.astype(jnp.float32)
    y = xf * lax.rsqrt(jnp.mean(xf * xf, axis=-1, keepdims=True) + EPS)
    return (y * w.astype(jnp.float32)).astype(x.dtype)


def layer_norm(x, w, b):
    xf = x.astype(jnp.float32)
    mu = jnp.mean(xf, axis=-1, keepdims=True)
    var = jnp.mean(jnp.square(xf - mu), axis=-1, keepdims=True)
    y = (xf - mu) * lax.rsqrt(var + EPS)
    return (y * w.astype(jnp.float32) + b.astype(jnp.float32)).astype(x.dtype)


def chunked_sgu(u, v, ln_w, ln_b, w_s, b_s):
    B, S, _ = v.shape
    n = S // SGU_CHUNK
    v = layer_norm(v, ln_w, ln_b)
    vc = v.reshape(B, n, SGU_CHUNK, SGU_GROUPS, SGU_GROUP_DIM)
    mask = jnp.tril(jnp.ones((SGU_CHUNK, SGU_CHUNK), dtype=bool))
    w = jnp.where(mask[None], w_s, jnp.zeros_like(w_s)).astype(v.dtype)
    mixed = jnp.einsum('gts,bnsgc->bntgc', w, vc) + b_s.T.astype(v.dtype)[:, :, None]
    return u * mixed.reshape(B, S, SGU_WIDTH)


def gla(q, k, v, gk, r, norm_w):
    out_dtype = q.dtype
    B, S, _ = q.shape
    n = S // GLA_CHUNK

    def heads(t, d):
        return t.astype(jnp.float32).reshape(B, n, GLA_CHUNK, GLA_HEADS, d).transpose(0, 3, 1, 2, 4)

    qh = heads(q, GLA_HEAD_DK) * (GLA_HEAD_DK ** -0.5)
    kh = heads(k, GLA_HEAD_DK)
    vh = heads(v, GLA_HEAD_DV)
    g = heads(gk, GLA_HEAD_DK)
    b = jnp.cumsum(g, axis=3)
    b_last = b[:, :, :, -1:, :]
    q_dec = qh * jnp.exp(b)
    k_dec = kh * jnp.exp(-b)
    k_end = kh * jnp.exp(b_last - b)
    mask = jnp.tril(jnp.ones((GLA_CHUNK, GLA_CHUNK), dtype=bool))
    scores = jnp.einsum('bhntd,bhnsd->bhnts', q_dec, k_dec)
    scores = jnp.where(mask, scores, 0.0)
    o_intra = jnp.einsum('bhnts,bhnsv->bhntv', scores, vh)
    kv = jnp.einsum('bhnsd,bhnsv->bhndv', k_end, vh)
    decay = jnp.exp(b_last[:, :, :, 0, :])

    def step(state, inp):
        dec, kv_n = inp
        return dec[..., None] * state + kv_n, state

    s0 = jnp.zeros((B, GLA_HEADS, GLA_HEAD_DK, GLA_HEAD_DV), jnp.float32)
    _, s_prev = lax.scan(step, s0, (jnp.moveaxis(decay, 2, 0), jnp.moveaxis(kv, 2, 0)))
    s_prev = jnp.moveaxis(s_prev, 0, 2)
    o = o_intra + jnp.einsum('bhntd,bhndv->bhntv', q_dec, s_prev)
    o = o * lax.rsqrt(jnp.mean(o * o, axis=-1, keepdims=True) + EPS) * norm_w.astype(jnp.float32)
    o = o.transpose(0, 2, 3, 1, 4).reshape(B, S, GLA_DV)
    return (o * jax.nn.silu(r.astype(jnp.float32))).astype(out_dtype)


def setup_inputs(seed: int = 0) -> dict:
    key = jax.random.key(seed)
    ks = jax.random.split(key, 24)
    L = DEPTH
    nrm = jax.random.normal

    def dense(k, fan_in, fan_out):
        return nrm(k, (L, fan_in, fan_out), jnp.float32) * fan_in ** -0.5

    def gain(k, d):
        return 1.0 + 0.05 * nrm(k, (L, d), jnp.float32)

    return {
        "x": nrm(ks[0], (BATCH, SEQ, D_MODEL), jnp.float32),
        "norm1_w": gain(ks[1], D_MODEL),
        "w_in": dense(ks[2], D_MODEL, IN_COLS),
        "b_in": 0.02 * nrm(ks[3], (L, IN_COLS), jnp.float32),
        "sgu_ln_w": gain(ks[4], SGU_WIDTH),
        "sgu_ln_b": 0.02 * nrm(ks[5], (L, SGU_WIDTH), jnp.float32),
        "sgu_w": 0.5 * SGU_CHUNK ** -0.5 * nrm(ks[6], (L, SGU_GROUPS, SGU_CHUNK, SGU_CHUNK), jnp.float32),
        "sgu_b": 1.0 + 0.1 * nrm(ks[7], (L, SGU_GROUPS, SGU_CHUNK), jnp.float32),
        "w_gk2": dense(ks[8], GLA_LOWRANK, GLA_DK),
        "b_gk": 0.1 * nrm(ks[9], (L, GLA_DK), jnp.float32),
        "gla_norm_w": gain(ks[10], GLA_HEAD_DV),
        "w_branch_a": dense(ks[11], SGU_WIDTH, D_MODEL),
        "w_branch_b": dense(ks[12], GLA_DV, D_MODEL),
        "w_out": dense(ks[13], D_MODEL, D_MODEL),
        "norm2_w": gain(ks[14], D_MODEL),
        "w_ffn_gate": dense(ks[15], D_MODEL, D_FF),
        "w_ffn_up": dense(ks[16], D_MODEL, D_FF),
        "w_ffn_down": dense(ks[17], D_FF, D_MODEL),
        "final_norm_w": 1.0 + 0.05 * nrm(ks[18], (D_MODEL,), jnp.float32),
    }


def reference(x, norm1_w, w_in, b_in, sgu_ln_w, sgu_ln_b, sgu_w, sgu_b, w_gk2, b_gk,
              gla_norm_w, w_branch_a, w_branch_b, w_out, norm2_w, w_ffn_gate, w_ffn_up,
              w_ffn_down, final_norm_w):
    split_points = [int(s) for s in np.cumsum(IN_SIZES)[:-1]]
    h = x
    for l in range(DEPTH):
        xn = rms_norm(h, norm1_w[l])
        proj = xn @ w_in[l] + b_in[l]
        u, v, q, k, vg, r, g_lr, gate_a, gate_b = jnp.split(proj, split_points, axis=-1)
        ya = chunked_sgu(jax.nn.gelu(u), jax.nn.gelu(v), sgu_ln_w[l], sgu_ln_b[l], sgu_w[l], sgu_b[l])
        gk = jax.nn.log_sigmoid((g_lr @ w_gk2[l] + b_gk[l]).astype(jnp.float32)) / GLA_GATE_NORMALIZER
        yb = gla(q, k, vg, gk, r, gla_norm_w[l])
        merged = jax.nn.sigmoid(gate_a) * (ya @ w_branch_a[l]) + jax.nn.sigmoid(gate_b) * (yb @ w_branch_b[l])
        h = h + merged @ w_out[l]
        xn2 = rms_norm(h, norm2_w[l])
        h = h + (jax.nn.silu(xn2 @ w_ffn_gate[l]) * (xn2 @ w_ffn_up[l])) @ w_ffn_down[l]
    return rms_norm(h, final_norm_w)
```

```cpp
#include <hip/hip_runtime.h>
#include <cstdio>
#include <cstdint>

constexpr int D = 1024, BATCH = 4, SEQ = 4096, M = BATCH * SEQ;
constexpr int IN_COLS = 7184, NPROJ = 7168;
constexpr int LR_COL0 = 5120, LR = 16;
constexpr int DFF = 2816, NGU = 2 * DFF;
constexpr int GH = 4, GDK = 128, GDV = 256, GCH = 64, NCH = SEQ / GCH;
constexpr int NITEM = BATCH * GH * NCH;
constexpr float EPS = 1e-6f;

namespace pg8 {
#define PG8_LAS __attribute__((address_space(3)))
typedef unsigned short bf16_t;
typedef short bf16x8 __attribute__((ext_vector_type(8)));
typedef float f32x4 __attribute__((ext_vector_type(4)));
typedef float f32x2 __attribute__((ext_vector_type(2)));
typedef unsigned u32x4 __attribute__((ext_vector_type(4)));
typedef unsigned u32x2 __attribute__((ext_vector_type(2)));
constexpr int BM = 256, BK = 64, HALF = 128, HTB = HALF * BK * 2, STAGE_BYTES = 8 * HTB, NXCD = 8, WGM = 8;

__host__ __device__ __forceinline__ int lds_byte(int r, int c) { const int st = (r >> 4) * 2 + (c >> 5), rr = r & 15, cc = c & 31, ob = rr * 64 + cc * 2; return st * 1024 + (ob ^ (((ob >> 9) & 1) << 5)); }
__host__ __device__ __forceinline__ void stage_rc(int b, int& R, int& C) { const int st = b / 1024, sb = b % 1024, swz = sb ^ (((sb >> 9) & 1) << 5); R = (st >> 1) * 16 + swz / 64; C = (st & 1) * 32 + (swz % 64) / 2; }
__host__ __device__ __forceinline__ int perm32(int rho) { const int n = rho >> 4, i = rho & 15; return 8 * (i >> 2) + 4 * n + (i & 3); }

struct Unit { int pm, pn, z; };
struct Gemm { const bf16_t* A; const bf16_t* Bt; int M, N, K, lda, ldb; size_t zA, zB; };

struct StaticOrder {
    int nM, nN, nwg, G, c, nz;
    __host__ __device__ void init(int M_, int N_, int G_, int c_, int nz_ = 1) { nM = M_ / BM; nN = N_ / BM; nwg = nM * nN; G = G_; c = c_; nz = nz_; }
    __host__ __device__ bool next(int i, Unit& u) const {
        const int round = i / nz; u.z = i % nz;
        const long L = (long)round * G + c; if (L >= nwg) return false;
        int wgid = (int)L; { const int q = nwg / NXCD, r = nwg % NXCD, xcd = wgid % NXCD, off = wgid / NXCD; wgid = (xcd < r ? xcd * (q + 1) : r * (q + 1) + (xcd - r) * q) + off; }
        const int nig = WGM * nN, gid = wgid / nig, fm = gid * WGM, gsz = (nM - fm) < WGM ? (nM - fm) : WGM;
        u.pm = fm + ((wgid % nig) % gsz); u.pn = (wgid % nig) / gsz; return true;
    }
};

__device__ __forceinline__ unsigned cvt_pk_bf16(float lo, float hi) { unsigned r; asm volatile("v_cvt_pk_bf16_f32 %0, %1, %2" : "=v"(r) : "v"(lo), "v"(hi)); return r; }
__device__ __forceinline__ float bf_lo(unsigned w) { return __uint_as_float(w << 16); }
__device__ __forceinline__ float bf_hi(unsigned w) { return __uint_as_float(w & 0xffff0000u); }
__device__ __forceinline__ float sigmoidf_fast(float z) { return __builtin_amdgcn_rcpf(1.0f + __builtin_amdgcn_exp2f(-1.4426950408889634f * z)); }


struct EpiInProj {
    static constexpr bool PERM = true;
    bf16_t* yab; bf16_t* gv; bf16_t* q; bf16_t* k; bf16_t* r; bf16_t* ga; bf16_t* gb; const float* bias;
    __device__ __forceinline__ f32x4 act(f32x4 v, int type) const {
        if (type == 0) {
#pragma unroll
            for (int e = 0; e < 4; ++e) { const float x = v[e]; const float z = 1.5957691216057308f * (x + 0.044715f * x * x * x); v[e] = x * sigmoidf_fast(z); }
        } else if (type == 1) { v = v * 0.08838834764831845f;
        } else if (type == 3) {
#pragma unroll
            for (int e = 0; e < 4; ++e) v[e] = v[e] * sigmoidf_fast(v[e]);
        } else if (type == 4) {
#pragma unroll
            for (int e = 0; e < 4; ++e) v[e] = sigmoidf_fast(v[e]);
        }
        return v;
    }
    __device__ __forceinline__ void operator()(const f32x4 (&acc)[2][2][4][2], const Unit& u, int wr, int wc, int fr, int fq) const {
        const int pn = u.pn; bf16_t* base; int ldc, type, ocol;
        if (pn < 4)       { base = yab; ldc = 2048; type = 0; ocol = pn * 256; }
        else if (pn < 8)  { base = gv;  ldc = 1024; type = 0; ocol = (pn - 4) * 256; }
        else if (pn < 10) { base = q;   ldc = 512;  type = 1; ocol = (pn - 8) * 256; }
        else if (pn < 12) { base = k;   ldc = 512;  type = 2; ocol = (pn - 10) * 256; }
        else if (pn < 16) { base = yab; ldc = 2048; type = 2; ocol = 1024 + (pn - 12) * 256; }
        else if (pn < 20) { base = r;   ldc = 1024; type = 3; ocol = (pn - 16) * 256; }
        else if (pn < 24) { base = ga;  ldc = 1024; type = 4; ocol = (pn - 20) * 256; }
        else              { base = gb;  ldc = 1024; type = 4; ocol = (pn - 24) * 256; }
        const int bcol_t = pn * 256 + (pn >= 20 ? LR : 0);
        const int row0 = u.pm * BM + wr * 64 + fr;
        const int col0 = ocol + wc * 32 + 8 * fq, bcol0 = bcol_t + wc * 32 + 8 * fq;
        f32x4 bv[2][2];
#pragma unroll
        for (int bj = 0; bj < 2; ++bj)
#pragma unroll
            for (int n = 0; n < 2; ++n) bv[bj][n] = *(const f32x4*)(bias + bcol0 + bj * HALF + 4 * n);
#pragma unroll
        for (int ai = 0; ai < 2; ++ai)
#pragma unroll
            for (int m = 0; m < 4; ++m) { bf16_t* rowp = base + (size_t)(row0 + ai * HALF + m * 16) * ldc + col0;
#pragma unroll
                for (int bj = 0; bj < 2; ++bj) { f32x4 v0 = act(acc[ai][bj][m][0] + bv[bj][0], type), v1 = act(acc[ai][bj][m][1] + bv[bj][1], type);
                    u32x4 w; w.x = cvt_pk_bf16(v0[0], v0[1]); w.y = cvt_pk_bf16(v0[2], v0[3]); w.z = cvt_pk_bf16(v1[0], v1[1]); w.w = cvt_pk_bf16(v1[2], v1[3]);
                    *(u32x4*)(rowp + bj * HALF) = w; } }
    }
};
struct EpiBranch {
    static constexpr bool PERM = true;
    bf16_t* merged; const bf16_t* ga; const bf16_t* gb;
    __device__ __forceinline__ void operator()(const f32x4 (&acc)[2][2][4][2], const Unit& u, int wr, int wc, int fr, int fq) const {
        const int row0 = u.pm * BM + wr * 64 + fr, col0 = u.pn * BM + wc * 32 + 8 * fq;
        const bf16_t* gate = u.z == 0 ? ga : gb;
#pragma unroll
        for (int ai = 0; ai < 2; ++ai)
#pragma unroll
            for (int m = 0; m < 4; ++m) { const size_t off = (size_t)(row0 + ai * HALF + m * 16) * D + col0;
#pragma unroll
                for (int bj = 0; bj < 2; ++bj) {
                    const u32x4 g = *(const u32x4*)(gate + off + bj * HALF);
                    float o[8];
                    o[0] = acc[ai][bj][m][0][0] * bf_lo(g.x); o[1] = acc[ai][bj][m][0][1] * bf_hi(g.x); o[2] = acc[ai][bj][m][0][2] * bf_lo(g.y); o[3] = acc[ai][bj][m][0][3] * bf_hi(g.y);
                    o[4] = acc[ai][bj][m][1][0] * bf_lo(g.z); o[5] = acc[ai][bj][m][1][1] * bf_hi(g.z); o[6] = acc[ai][bj][m][1][2] * bf_lo(g.w); o[7] = acc[ai][bj][m][1][3] * bf_hi(g.w);
                    if (u.z != 0) { const u32x4 t = *(const u32x4*)(merged + off + bj * HALF);
                        o[0] += bf_lo(t.x); o[1] += bf_hi(t.x); o[2] += bf_lo(t.y); o[3] += bf_hi(t.y); o[4] += bf_lo(t.z); o[5] += bf_hi(t.z); o[6] += bf_lo(t.w); o[7] += bf_hi(t.w); }
                    u32x4 w; w.x = cvt_pk_bf16(o[0], o[1]); w.y = cvt_pk_bf16(o[2], o[3]); w.z = cvt_pk_bf16(o[4], o[5]); w.w = cvt_pk_bf16(o[6], o[7]);
                    *(u32x4*)(merged + off + bj * HALF) = w; } }
    }
};
struct EpiResid {
    static constexpr bool PERM = false;
    const float* base; float* out; bf16_t* hb; float* rowsq;
    __device__ __forceinline__ void operator()(const f32x4 (&acc)[2][2][4][2], const Unit& u, int wr, int wc, int fr, int fq) const {
        const int row0 = u.pm * BM + wr * 64 + fr, col0 = u.pn * BM + wc * 32 + 4 * fq;
#pragma unroll
        for (int ai = 0; ai < 2; ++ai)
#pragma unroll
            for (int m = 0; m < 4; ++m) { const int row = row0 + ai * HALF + m * 16; const size_t off = (size_t)row * D + col0; float ss = 0.f;
#pragma unroll
                for (int bj = 0; bj < 2; ++bj)
#pragma unroll
                    for (int n = 0; n < 2; ++n) { const f32x4 h = *(const f32x4*)(base + off + bj * HALF + n * 16) + acc[ai][bj][m][n];
                        *(f32x4*)(out + off + bj * HALF + n * 16) = h; ss += (h[0] * h[0] + h[1] * h[1]) + (h[2] * h[2] + h[3] * h[3]);
                        if (hb) { u32x2 w; w.x = cvt_pk_bf16(h[0], h[1]); w.y = cvt_pk_bf16(h[2], h[3]); *(u32x2*)(hb + off + bj * HALF + n * 16) = w; } }
                ss += __shfl_xor(ss, 16); ss += __shfl_xor(ss, 32);
                if (fq == 0) atomicAdd(rowsq + row, ss); }
    }
};
struct EpiSwiGLU {
    static constexpr bool PERM = true;
    bf16_t* act; const float* rowsq;
    __device__ __forceinline__ void operator()(const f32x4 (&acc)[2][2][4][2], const Unit& u, int wr, int wc, int fr, int fq) const {
        const int row0 = u.pm * BM + wr * 64 + fr, col0 = u.pn * HALF + wc * 32 + 8 * fq;
#pragma unroll
        for (int ai = 0; ai < 2; ++ai)
#pragma unroll
            for (int m = 0; m < 4; ++m) { const int row = row0 + ai * HALF + m * 16; const float rs = 1.0f / sqrtf(rowsq[row] * (1.0f / D) + EPS);
                float o[8];
#pragma unroll
                for (int n = 0; n < 2; ++n)
#pragma unroll
                    for (int e = 0; e < 4; ++e) { const float g = acc[ai][0][m][n][e] * rs, up = acc[ai][1][m][n][e] * rs; o[n * 4 + e] = g * sigmoidf_fast(g) * up; }
                u32x4 w; w.x = cvt_pk_bf16(o[0], o[1]); w.y = cvt_pk_bf16(o[2], o[3]); w.z = cvt_pk_bf16(o[4], o[5]); w.w = cvt_pk_bf16(o[6], o[7]);
                *(u32x4*)(act + (size_t)row * DFF + col0) = w; }
    }
};

template <class Epi, class Sched, bool ALIGN_EPI>
__device__ __forceinline__ void gemm_phase(PG8_LAS unsigned char* lds, const Gemm g, const Sched& S, const Epi& E) {
    const int tid = threadIdx.x, wid = __builtin_amdgcn_readfirstlane(tid >> 6), lane = tid & 63, wr = wid >> 2, wc = wid & 3, fr = lane & 15, fq = lane >> 4;
    const int K = g.K, nt = K / BK;
    unsigned voffA[2], voffB[2];
#pragma unroll
    for (int i = 0; i < 2; ++i) { int R, C; stage_rc(tid * 16 + i * 8192, R, C); const int Rb = Epi::PERM ? ((R & ~31) + perm32(R & 31)) : R;
        voffA[i] = (unsigned)(R * g.lda + C) * 2u; voffB[i] = (unsigned)(Rb * g.ldb + C) * 2u; }
    const size_t kstep = (size_t)(BK * 2);
    const size_t hstepA = (size_t)HALF * g.lda * 2, hstepB = (size_t)HALF * g.ldb * 2;
    const size_t tstepA = 2 * hstepA, tstepB = 2 * hstepB;
    const unsigned ldsw = (unsigned)wid * 1024u;
    const int aoff = lds_byte(wr * 64 + fr, fq * 8), boff = lds_byte(wc * 32 + fr, fq * 8);
#define PG8_SA(b, h) (((b) * 2 + (h)) * HTB)
#define PG8_SB(b, h) ((4 + (b) * 2 + (h)) * HTB)
#define PG8_STAGE(bufoff, gbase, voff) do { _Pragma("unroll") for (int _i = 0; _i < 2; ++_i) \
        __builtin_amdgcn_global_load_lds((const unsigned*)((const char*)(gbase) + (voff)[_i]), (PG8_LAS unsigned*)(lds + (bufoff) + ldsw + _i * 8192), 16, 0, 0); } while (0)
#define PG8_LDA(dst, b, h) do { _Pragma("unroll") for (int m = 0; m < 4; ++m) _Pragma("unroll") for (int k = 0; k < 2; ++k) dst[m][k] = *(const PG8_LAS bf16x8*)(lds + PG8_SA(b, h) + aoff + m * 2048 + k * 1024); } while (0)
#define PG8_LDB(dst, b, h) do { _Pragma("unroll") for (int n = 0; n < 2; ++n) _Pragma("unroll") for (int k = 0; k < 2; ++k) dst[n][k] = *(const PG8_LAS bf16x8*)(lds + PG8_SB(b, h) + boff + n * 2048 + k * 1024); } while (0)
#define PG8_MMA(ai, bj, At, Bt) do { __builtin_amdgcn_s_setprio(1); _Pragma("unroll") for (int m = 0; m < 4; ++m) _Pragma("unroll") for (int n = 0; n < 2; ++n) _Pragma("unroll") for (int k = 0; k < 2; ++k) \
        acc[ai][bj][m][n] = __builtin_amdgcn_mfma_f32_16x16x32_bf16(Bt[n][k], At[m][k], acc[ai][bj][m][n], 0, 0, 0); __builtin_amdgcn_s_setprio(0); } while (0)
#define PG8_WAIT_V(n) asm volatile("s_waitcnt vmcnt(" #n ")" ::: "memory")
#define PG8_WAIT_L(n) asm volatile("s_waitcnt lgkmcnt(" #n ")" ::: "memory")
#define PG8_BAR __builtin_amdgcn_s_barrier()
#define PG8_SCHED __builtin_amdgcn_sched_barrier(0)
    Unit cur, nxt; int ui = 0;
    if (!S.next(0, cur)) return;
    f32x4 acc[2][2][4][2];
#pragma unroll
    for (int a = 0; a < 2; ++a)
#pragma unroll
        for (int b = 0; b < 2; ++b)
#pragma unroll
            for (int m = 0; m < 4; ++m)
#pragma unroll
                for (int n = 0; n < 2; ++n) acc[a][b][m][n] = (f32x4){0.f, 0.f, 0.f, 0.f};
    bf16x8 At[4][2], B0[2][2], B1[2][2];
    const char* cA = (const char*)g.A + (size_t)cur.z * g.zA + (size_t)cur.pm * tstepA; const char* cB = (const char*)g.Bt + (size_t)cur.z * g.zB + (size_t)cur.pn * tstepB;
    PG8_STAGE(PG8_SB(0, 0), cB, voffB); PG8_STAGE(PG8_SB(0, 1), cB + hstepB, voffB); PG8_STAGE(PG8_SA(0, 0), cA, voffA); PG8_STAGE(PG8_SA(0, 1), cA + hstepA, voffA);
    if (wr == 1) PG8_BAR;
    PG8_WAIT_V(2); PG8_BAR;
    PG8_STAGE(PG8_SB(1, 0), cB + kstep, voffB); PG8_STAGE(PG8_SA(1, 0), cA + kstep, voffA); PG8_STAGE(PG8_SB(1, 1), cB + hstepB + kstep, voffB);
    PG8_WAIT_V(6); PG8_BAR;
    for (;;) {
        const bool has_next = S.next(ui + 1, nxt);
        const char* nA = has_next ? (const char*)g.A + (size_t)nxt.z * g.zA + (size_t)nxt.pm * tstepA : cA; const char* nB = has_next ? (const char*)g.Bt + (size_t)nxt.z * g.zB + (size_t)nxt.pn * tstepB : cB;
        for (int t = 0; t < nt; t += 2) {
            const bool last = (t == nt - 2);
            const char* a1 = cA + (size_t)(t + 1) * kstep;
            const char* a2 = last ? nA : cA + (size_t)(t + 2) * kstep; const char* b2 = last ? nB : cB + (size_t)(t + 2) * kstep;
            const char* a3 = a2 + kstep; const char* b3 = b2 + kstep;
            PG8_LDB(B0, 0, 0); PG8_LDB(B1, 0, 1); PG8_SCHED; PG8_LDA(At, 0, 0); PG8_STAGE(PG8_SA(1, 1), a1 + hstepA, voffA);
            PG8_WAIT_V(8); PG8_WAIT_L(0); PG8_BAR; PG8_MMA(0, 0, At, B0); PG8_MMA(0, 1, At, B1); PG8_BAR; PG8_SCHED;
            PG8_LDA(At, 0, 1); PG8_STAGE(PG8_SB(0, 0), b2, voffB); PG8_STAGE(PG8_SB(0, 1), b2 + hstepB, voffB); PG8_STAGE(PG8_SA(0, 0), a2, voffA);
            PG8_WAIT_V(8); PG8_WAIT_L(0); PG8_BAR; PG8_MMA(1, 0, At, B0); PG8_MMA(1, 1, At, B1); PG8_BAR; PG8_SCHED;
            PG8_LDB(B0, 1, 0); PG8_LDB(B1, 1, 1); PG8_SCHED; PG8_LDA(At, 1, 0); PG8_STAGE(PG8_SA(0, 1), a2 + hstepA, voffA);
            PG8_WAIT_V(8); PG8_WAIT_L(0); PG8_BAR; PG8_MMA(0, 0, At, B0); PG8_MMA(0, 1, At, B1); PG8_BAR; PG8_SCHED;
            PG8_LDA(At, 1, 1); PG8_STAGE(PG8_SB(1, 0), b3, voffB); PG8_STAGE(PG8_SB(1, 1), b3 + hstepB, voffB); PG8_STAGE(PG8_SA(1, 0), a3, voffA);
            PG8_WAIT_V(8); PG8_WAIT_L(0); PG8_BAR; PG8_MMA(1, 0, At, B0); PG8_MMA(1, 1, At, B1); PG8_BAR; PG8_SCHED;
        }
        if constexpr (ALIGN_EPI) { if (wr == 0) PG8_BAR; }
        E(acc, cur, wr, wc, fr, fq);
        if (!has_next) break;
#pragma unroll
        for (int a = 0; a < 2; ++a)
#pragma unroll
            for (int b = 0; b < 2; ++b)
#pragma unroll
                for (int m = 0; m < 4; ++m)
#pragma unroll
                    for (int n = 0; n < 2; ++n) acc[a][b][m][n] = (f32x4){0.f, 0.f, 0.f, 0.f};
        cur = nxt; cA = nA; cB = nB; ++ui;
        if constexpr (ALIGN_EPI) { if (wr == 1) PG8_BAR; }
    }
    PG8_WAIT_V(0);
    if constexpr (!ALIGN_EPI) { if (wr == 0) PG8_BAR; }
    PG8_BAR;
#undef PG8_SA
#undef PG8_SB
#undef PG8_STAGE
#undef PG8_LDA
#undef PG8_LDB
#undef PG8_MMA
#undef PG8_WAIT_V
#undef PG8_WAIT_L
#undef PG8_BAR
#undef PG8_SCHED
}
}

constexpr size_t MiB = 1u << 20;
constexpr size_t WS_CTL = 0, CTL_ZERO_BYTES = 64 * 1024;
constexpr size_t WS_GLR = 1 * MiB;
constexpr size_t WS_RSQ1 = 2 * MiB, WS_RSQ2 = 2 * MiB + 64 * 1024;
constexpr size_t WS_DECAY = 2 * MiB + 512 * 1024;
constexpr size_t WS_WIN = 6 * MiB;
constexpr size_t WS_WLR = 20 * MiB;
constexpr size_t WS_WAB = 20 * MiB + 512 * 1024;
constexpr size_t WS_WOUT = WS_WAB + 4 * MiB;
constexpr size_t WS_WGU = WS_WOUT + 2 * MiB;
constexpr size_t WS_WDN = WS_WGU + 11 * MiB;
constexpr size_t WS_YAB = 44 * MiB;
constexpr size_t WS_GV = 108 * MiB;
constexpr size_t WS_Q = 140 * MiB, WS_K = 156 * MiB;
constexpr size_t WS_R = 172 * MiB;
constexpr size_t WS_GA = 204 * MiB;
constexpr size_t WS_ACT = 108 * MiB;
constexpr size_t WS_END = 256 * MiB;
static_assert(WS_WDN + (size_t)D * DFF * 2 <= WS_YAB && WS_ACT + (size_t)M * DFF * 2 <= WS_GA && WS_GA + (size_t)M * D * 2 <= WS_END, "d_ws map");

constexpr int RING_BYTES = 131072, LDSCTL_OFF = RING_BYTES, MISC_OFF = LDSCTL_OFF + 320, LDS_BYTES = 147456;
constexpr int NWAVES = 8;

#define GAS __attribute__((address_space(1)))
#define LAS __attribute__((address_space(3)))
typedef unsigned short bf16;
typedef unsigned v4u __attribute__((ext_vector_type(4)));
typedef unsigned v2u __attribute__((ext_vector_type(2)));
typedef float f32x4 __attribute__((ext_vector_type(4)));
typedef short bf16x8 __attribute__((ext_vector_type(8)));
typedef short s16x4 __attribute__((ext_vector_type(4)));
typedef GAS unsigned gu32;
#define RLX_AGENT __ATOMIC_RELAXED, __HIP_MEMORY_SCOPE_AGENT
#define LDS_WAIT() asm volatile("s_waitcnt lgkmcnt(0)" ::: "memory")
#define VM_WAIT() asm volatile("s_waitcnt vmcnt(0)" ::: "memory")
__device__ __forceinline__ unsigned f2bf(float f) { unsigned u = __builtin_bit_cast(unsigned, f); return (u + 0x7fffu + ((u >> 16) & 1u)) >> 16; }
__device__ __forceinline__ unsigned pk2(float lo, float hi) { return f2bf(lo) | (f2bf(hi) << 16); }
__device__ __forceinline__ float bflo(unsigned w) { return __uint_as_float(w << 16); }
__device__ __forceinline__ float bfhi(unsigned w) { return __uint_as_float(w & 0xffff0000u); }

#define XB_TMO      128
#define XB_XCNT(j)  (256  + 64 * (j))
#define XB_XSUB(j)  (1280 + 64 * (j))
#define XB_XGEN(j)  (2304 + 64 * (j))
#define XB_TOP      3328
#define XB_TOPGEN   3392
#define XCD_BAR_WORDS 3456
#define XB_SPIN_CAP (1u << 18)
__device__ __forceinline__ unsigned xb_ld(unsigned* p)              { return __hip_atomic_load(p, __ATOMIC_RELAXED, __HIP_MEMORY_SCOPE_AGENT); }
__device__ __forceinline__ unsigned xb_add(unsigned* p, unsigned v) { return __hip_atomic_fetch_add(p, v, __ATOMIC_RELAXED, __HIP_MEMORY_SCOPE_AGENT); }
__device__ __forceinline__ unsigned xb_xcc_id() { return (unsigned)__builtin_amdgcn_s_getreg((3 << 11) | 20) & 0xFu; }
#define XB_SPIN(cond, bar) do { unsigned _sp = 0; while (cond) { __builtin_amdgcn_s_sleep(1); \
    if ((++_sp & 255u) == 0u) { if (xb_ld(&(bar)[XB_TMO])) break; if (_sp > XB_SPIN_CAP) { atomicAdd(&(bar)[XB_TMO], 1u); break; } } } } while (0)
struct XcdBarrier { unsigned* bar; unsigned x; volatile LAS unsigned* st; };
__device__ __forceinline__ XcdBarrier xcd_barrier_post(unsigned* bar, volatile LAS unsigned* st) {
    XcdBarrier b; b.bar = bar; b.x = xb_xcc_id(); b.st = st;
    if (threadIdx.x == 0) (void)xb_add(&bar[XB_XCNT(b.x)], 1u);
    return b;
}
__device__ __forceinline__ void xcd_barrier_complete(unsigned* bar, unsigned x, unsigned& nloc, unsigned& nx) {
    const unsigned G = gridDim.x * gridDim.y * gridDim.z;
    unsigned sum, cnt, mine, sp = 0u;
    for (;;) {
        sum = 0u; cnt = 0u; mine = 0u;
#pragma unroll
        for (unsigned j = 0; j < 16; ++j) { const unsigned c = xb_ld(&bar[XB_XCNT(j)]); sum += c; cnt += (c > 0u) ? 1u : 0u; mine = (j == x) ? c : mine; }
        if (sum == G) break;
        __builtin_amdgcn_s_sleep(1);
        if ((++sp & 255u) == 0u) { if (xb_ld(&bar[XB_TMO])) break; if (sp > XB_SPIN_CAP) { atomicAdd(&bar[XB_TMO], 1u); break; } }
    }
    nloc = mine > 0u ? mine : 1u; nx = cnt > 0u ? cnt : 1u;
}
__device__ __forceinline__ void xcd_barrier(const XcdBarrier& b) {
    asm volatile("s_waitcnt vmcnt(0)" ::: "memory");
    __syncthreads();
    if (threadIdx.x == 0) {
        unsigned* bar = b.bar;
        __builtin_amdgcn_s_waitcnt(0);
        unsigned nloc = b.st[0], nx = b.st[1];
        if (nloc == 0u) { xcd_barrier_complete(bar, b.x, nloc, nx); b.st[0] = nloc; b.st[1] = nx; }
        const unsigned old = xb_add(&bar[XB_XSUB(b.x)], 1u);
        const unsigned gen = old / nloc;
        if (old + 1u == (gen + 1u) * nloc) {
            __builtin_amdgcn_fence(__ATOMIC_RELEASE, "agent");
            asm volatile("s_waitcnt vmcnt(0)" ::: "memory");
            const unsigned og = xb_add(&bar[XB_TOP], 1u);
            const unsigned tg = og / nx;
            if (og + 1u == (tg + 1u) * nx) xb_add(&bar[XB_TOPGEN], 1u);
            else XB_SPIN(xb_ld(&bar[XB_TOPGEN]) == tg, bar);
            __builtin_amdgcn_fence(__ATOMIC_ACQUIRE, "agent");
            xb_add(&bar[XB_XGEN(b.x)], 1u);
            asm volatile("s_waitcnt vmcnt(0)" ::: "memory");
        } else {
            XB_SPIN(xb_ld(&bar[XB_XGEN(b.x)]) == gen, bar);
            __builtin_amdgcn_fence(__ATOMIC_ACQUIRE, "agent");
            asm volatile("s_waitcnt vmcnt(0)" ::: "memory");
        }
    }
    __syncthreads();
}

struct Frame {
    LAS unsigned char* lds;
    int tid, lane, wave, vcu, G;
    const float* in[19]; float* out; unsigned char* ws;
};
__device__ __forceinline__ float wave_sum(float v) {
#pragma unroll
    for (int o = 1; o < 64; o <<= 1) v += __shfl_xor(v, o);
    return v;
}
__device__ __forceinline__ void unpack8(const v4u w, float (&f)[8]) { f[0] = bflo(w.x); f[1] = bfhi(w.x); f[2] = bflo(w.y); f[3] = bfhi(w.y); f[4] = bflo(w.z); f[5] = bfhi(w.z); f[6] = bflo(w.w); f[7] = bfhi(w.w); }
__device__ __forceinline__ v4u pack8(const float (&f)[8]) { v4u w; w.x = pk2(f[0], f[1]); w.y = pk2(f[2], f[3]); w.z = pk2(f[4], f[5]); w.w = pk2(f[6], f[7]); return w; }

__device__ __forceinline__ bf16x8 frag_nat(const LAS unsigned char* tile, int stride_b, int x0, int k0, int lane) {
    return *(const LAS bf16x8*)(tile + (x0 + (lane & 15)) * stride_b + (k0 + 8 * (lane >> 4)) * 2);
}
__device__ __forceinline__ bf16x8 frag_tr(const LAS unsigned char* tile, int stride_b, int k0, int x0, int lane) {
    const int i = lane & 15, g = lane >> 4;
    const LAS unsigned char* p = tile + (k0 + 8 * g + (i >> 2)) * stride_b + (x0 + 4 * (i & 3)) * 2;
    const s16x4 lo = __builtin_bit_cast(s16x4, __builtin_amdgcn_ds_read_tr16_b64_v4i16((LAS s16x4*)p));
    const s16x4 hi = __builtin_bit_cast(s16x4, __builtin_amdgcn_ds_read_tr16_b64_v4i16((LAS s16x4*)(p + 4 * stride_b)));
    return (bf16x8){lo[0], lo[1], lo[2], lo[3], hi[0], hi[1], hi[2], hi[3]};
}
#define MFMA16(a, b, c) __builtin_amdgcn_mfma_f32_16x16x32_bf16((a), (b), (c), 0, 0, 0)

__device__ __forceinline__ void p0_transpose_block(const float* W, int ldw, bf16* WT, int ldt, const float* kscale, LAS float* scr, int lane) {
#pragma unroll 8
    for (int i = 0; i < 32; ++i) { const int kk = 2 * i + (lane >> 5); float v = W[(size_t)kk * ldw + (lane & 31)]; if (kscale) v *= kscale[kk]; scr[kk * 33 + (lane & 31)] = v; }
    LDS_WAIT(); asm volatile("" ::: "memory");
    const int c = lane & 7;
#pragma unroll
    for (int j = 0; j < 4; ++j) { const int n = (lane >> 3) + 8 * j; const LAS float* s = scr + (8 * c) * 33 + n;
        v4u o; o.x = pk2(s[0 * 33], s[1 * 33]); o.y = pk2(s[2 * 33], s[3 * 33]); o.z = pk2(s[4 * 33], s[5 * 33]); o.w = pk2(s[6 * 33], s[7 * 33]);
        *(GAS v4u*)(WT + (size_t)n * ldt + 8 * c) = o; }
    LDS_WAIT(); asm volatile("" ::: "memory");
}
__device__ __forceinline__ void p0_prologue(Frame& F) {
    LAS float* scr = (LAS float*)(F.lds + F.wave * 16384);
    const int gw = F.vcu * NWAVES + F.wave, NGW = F.G * NWAVES;
    const float* Win = F.in[2]; const float* Wa = F.in[11]; const float* Wb = F.in[12]; const float* Wo = F.in[13]; const float* n2w = F.in[14];
    const float* Wg = F.in[15]; const float* Wu = F.in[16]; const float* Wd = F.in[17];
    bf16* WinT = (bf16*)(F.ws + WS_WIN); bf16* WabT = (bf16*)(F.ws + WS_WAB); bf16* WoT = (bf16*)(F.ws + WS_WOUT); bf16* WguT = (bf16*)(F.ws + WS_WGU); bf16* WdT = (bf16*)(F.ws + WS_WDN);
    constexpr int I0 = 16 * 160, I1 = 16 * 64, I2 = 16 * 32, I5 = 16 * 88, I7 = 44 * 32;
    constexpr int NITEMS = I0 + I1 + 3 * I2 + 2 * I5 + I7;
    for (int it = gw; it < NITEMS; it += NGW) {
        int r = it;
        if (r < I0) { const int kb = r / 160, nb = r % 160; p0_transpose_block(Win + (size_t)(64 * kb) * IN_COLS + 32 * nb, IN_COLS, WinT + (size_t)(32 * nb) * D + 64 * kb, D, nullptr, scr, F.lane); continue; } r -= I0;
        if (r < I1) { const int kb = r / 64, nb = r % 64; p0_transpose_block(Win + (size_t)(64 * kb) * IN_COLS + LR_COL0 + LR + 32 * nb, IN_COLS, WinT + (size_t)(LR_COL0 + 32 * nb) * D + 64 * kb, D, nullptr, scr, F.lane); continue; } r -= I1;
        if (r < I2) { const int kb = r / 32, nb = r % 32; p0_transpose_block(Wa + (size_t)(64 * kb) * D + 32 * nb, D, WabT + (size_t)(32 * nb) * D + 64 * kb, D, nullptr, scr, F.lane); continue; } r -= I2;
        if (r < I2) { const int kb = r / 32, nb = r % 32; p0_transpose_block(Wb + (size_t)(64 * kb) * D + 32 * nb, D, WabT + (size_t)D * D + (size_t)(32 * nb) * D + 64 * kb, D, nullptr, scr, F.lane); continue; } r -= I2;
        if (r < I2) { const int kb = r / 32, nb = r % 32; p0_transpose_block(Wo + (size_t)(64 * kb) * D + 32 * nb, D, WoT + (size_t)(32 * nb) * D + 64 * kb, D, nullptr, scr, F.lane); continue; } r -= I2;
        if (r < I5) { const int kb = r / 88, nb = r % 88, n0 = 32 * nb, drow = 256 * (n0 / 128) + (n0 % 128);
            p0_transpose_block(Wg + (size_t)(64 * kb) * DFF + n0, DFF, WguT + (size_t)drow * D + 64 * kb, D, n2w + 64 * kb, scr, F.lane); continue; } r -= I5;
        if (r < I5) { const int kb = r / 88, nb = r % 88, n0 = 32 * nb, drow = 256 * (n0 / 128) + 128 + (n0 % 128);
            p0_transpose_block(Wu + (size_t)(64 * kb) * DFF + n0, DFF, WguT + (size_t)drow * D + 64 * kb, D, n2w + 64 * kb, scr, F.lane); continue; } r -= I5;
        { const int kb = r / 32, nb = r % 32; p0_transpose_block(Wd + (size_t)(64 * kb) * D + 32 * nb, D, WdT + (size_t)(32 * nb) * DFF + 64 * kb, DFF, nullptr, scr, F.lane); }
    }
    const int gt = gw * 64 + F.lane, NGT = NGW * 64;
    { bf16* WlrT = (bf16*)(F.ws + WS_WLR);
      for (int e = gt; e < LR * D; e += NGT) { const int j = e >> 10, k = e & 1023; WlrT[e] = (bf16)f2bf(Win[(size_t)k * IN_COLS + LR_COL0 + j]); } }
    { float* z = (float*)(F.ws + WS_RSQ1); for (int e = gt; e < 2 * M; e += NGT) z[e] = 0.f; }
    const float* x = F.in[0]; const float* n1w = F.in[1]; bf16* XN = (bf16*)F.out;
    f32x4 wv[4];
#pragma unroll
    for (int j = 0; j < 4; ++j) wv[j] = *((const f32x4*)n1w + F.lane + 64 * j);
    for (int m = gw; m < M; m += NGW) {
        const GAS f32x4* xr = (const GAS f32x4*)(x + (size_t)m * D) + F.lane;
        f32x4 v[4]; float s = 0.f;
#pragma unroll
        for (int j = 0; j < 4; ++j) { v[j] = xr[64 * j]; s += (v[j].x * v[j].x + v[j].y * v[j].y) + (v[j].z * v[j].z + v[j].w * v[j].w); }
        const float rs = 1.0f / sqrtf(wave_sum(s) * (1.f / D) + EPS);
        GAS unsigned long long* o8 = (GAS unsigned long long*)(XN + (size_t)m * D) + F.lane;
#pragma unroll
        for (int j = 0; j < 4; ++j) { const f32x4 y = v[j] * rs * wv[j]; o8[64 * j] = (unsigned long long)pk2(y.x, y.y) | ((unsigned long long)pk2(y.z, y.w) << 32); }
    }
}

__device__ __forceinline__ void glr_phase(Frame& F) {
    if (F.wave < 4) {
        const int tile = blockIdx.x * 4 + F.wave, r0 = tile * 16, lane = F.lane;
        if (tile < M / 16) {
            const bf16* XN = (const bf16*)F.out; const bf16* WlrT = (const bf16*)(F.ws + WS_WLR);
            f32x4 acc = {0.f, 0.f, 0.f, 0.f};
            const bf16* ap = XN + (size_t)(r0 + (lane & 15)) * D + 8 * (lane >> 4); const bf16* bp = WlrT + (size_t)(lane & 15) * D + 8 * (lane >> 4);
#pragma unroll 8
            for (int ks = 0; ks < 32; ++ks) { const bf16x8 a = *(const bf16x8*)(ap + 32 * ks), b = *(const bf16x8*)(bp + 32 * ks); acc = MFMA16(a, b, acc); }
            float* glr = (float*)(F.ws + WS_GLR); const float bias = F.in[3][LR_COL0 + (lane & 15)];
#pragma unroll
            for (int r = 0; r < 4; ++r) glr[(size_t)(r0 + 4 * (lane >> 4) + r) * LR + (lane & 15)] = acc[r] + bias;
        }
    }
}

__device__ __forceinline__ void sgu_phase(Frame& F) {
    constexpr int WST = 272, VST = 272;
    LAS unsigned char* Wl = F.lds; LAS unsigned char* Vl = F.lds + 128 * WST; LAS float* stat = (LAS float*)(F.lds + 128 * WST + 128 * VST);
    const int tid = F.tid, lane = F.lane, w = F.wave;
    const bf16* GV = (const bf16*)(F.ws + WS_GV); bf16* YAB = (bf16*)(F.ws + WS_YAB);
    const float* lnw = F.in[4]; const float* lnb = F.in[5]; const float* sw = F.in[6]; const float* sb = F.in[7];
    for (int cb = F.vcu; cb < 2 * (M / 128); cb += F.G) {
        const int chunk = cb >> 1, g0 = (cb & 1) * 4, tok0 = chunk * 128;
        for (int i = 0; i < 16; ++i) { const int t = w * 16 + i; const v4u* rp = (const v4u*)(GV + (size_t)(tok0 + t) * D) + lane * 2;
            float a[8], b[8]; unpack8(rp[0], a); unpack8(rp[1], b); float s = 0.f;
#pragma unroll
            for (int e = 0; e < 8; ++e) s += a[e] + b[e];
            const float mean = wave_sum(s) * (1.f / D); float q = 0.f;
#pragma unroll
            for (int e = 0; e < 8; ++e) { const float da = a[e] - mean, db = b[e] - mean; q += da * da + db * db; }
            const float rstd = 1.0f / sqrtf(wave_sum(q) * (1.f / D) + EPS);
            if (lane == 0) { stat[2 * t] = mean; stat[2 * t + 1] = rstd; } }
        __syncthreads();
        for (int gi = 0; gi < 4; ++gi) {
            const int g = g0 + gi;
            {
                const int t = tid >> 2, sq = tid & 3; const f32x4* wp = (const f32x4*)(sw + (size_t)g * 16384 + t * 128 + sq * 32);
#pragma unroll
                for (int i = 0; i < 4; ++i) { const f32x4 x0 = wp[2 * i], x1 = wp[2 * i + 1]; float f[8] = {x0[0], x0[1], x0[2], x0[3], x1[0], x1[1], x1[2], x1[3]};
#pragma unroll
                    for (int e = 0; e < 8; ++e) if (sq * 32 + 8 * i + e > t) f[e] = 0.f;
                    *(LAS v4u*)(Wl + t * WST + (sq * 32 + 8 * i) * 2) = pack8(f); } }
            {
                const int s = tid >> 2, cq = tid & 3; const float mean = stat[2 * s], rstd = stat[2 * s + 1];
                const v4u* vp = (const v4u*)(GV + (size_t)(tok0 + s) * D + g * 128 + cq * 32);
#pragma unroll
                for (int i = 0; i < 4; ++i) { float f[8]; unpack8(vp[i], f); const int c = g * 128 + cq * 32 + 8 * i;
                    const f32x4 w0 = *(const f32x4*)(lnw + c), w1 = *(const f32x4*)(lnw + c + 4), b0 = *(const f32x4*)(lnb + c), b1 = *(const f32x4*)(lnb + c + 4);
#pragma unroll
                    for (int e = 0; e < 4; ++e) { f[e] = (f[e] - mean) * rstd * w0[e] + b0[e]; f[4 + e] = (f[4 + e] - mean) * rstd * w1[e] + b1[e]; }
                    *(LAS v4u*)(Vl + s * VST + (cq * 32 + 8 * i) * 2) = pack8(f); } }
            __syncthreads();
            f32x4 acc[8];
#pragma unroll
            for (int nt = 0; nt < 8; ++nt) acc[nt] = (f32x4){0.f, 0.f, 0.f, 0.f};
            const int ksmax = (16 * w + 15) >> 5;
            for (int ks = 0; ks <= ksmax; ++ks) {
                const bf16x8 wf = frag_nat(Wl, WST, 16 * w, 32 * ks, lane);
#pragma unroll
                for (int nt = 0; nt < 8; ++nt) { const bf16x8 vf = frag_tr(Vl, VST, 32 * ks, 16 * nt, lane); acc[nt] = MFMA16(vf, wf, acc[nt]); }
            }
            const int t = 16 * w + (lane & 15); const float bs = sb[g * 128 + t];
            bf16* yp = YAB + (size_t)(tok0 + t) * 2048 + g * 128 + 4 * (lane >> 4);
#pragma unroll
            for (int nt = 0; nt < 8; ++nt) { const v2u gu = *(const v2u*)(yp + 16 * nt);
                v2u o; o.x = pk2(bflo(gu.x) * (acc[nt][0] + bs), bfhi(gu.x) * (acc[nt][1] + bs)); o.y = pk2(bflo(gu.y) * (acc[nt][2] + bs), bfhi(gu.y) * (acc[nt][3] + bs));
                *(v2u*)(yp + 16 * nt) = o; }
            __syncthreads();
        }
    }
}

constexpr int GL_B = 0, GL_GL = 32768, GL_TOT = 36864, GL_X = 38912, GL_Y = 56320, GL_V = 73728, GL_P = 107520, GL_RS = 116736;
constexpr int XST = 272, VSTG = 528, PST = 144;
__device__ __forceinline__ void gla_cumdecay(Frame& F, int T0, int h) {
    LAS float* B = (LAS float*)(F.lds + GL_B); LAS float* GLt = (LAS float*)(F.lds + GL_GL); LAS float* TOT = (LAS float*)(F.lds + GL_TOT);
    const int tid = F.tid; const float* glr = (const float*)(F.ws + WS_GLR); const float* wgk = F.in[8]; const float* bgk = F.in[9];
    if (tid < 256) *(LAS f32x4*)(GLt + tid * 4) = *(const f32x4*)(glr + (size_t)T0 * LR + tid * 4);
    const int d = tid & 127, tq = tid >> 7;
    float wr[16];
#pragma unroll
    for (int j = 0; j < 16; ++j) wr[j] = wgk[j * 512 + h * 128 + d];
    const float bg = bgk[h * 128 + d];
    __syncthreads();
    float run = 0.f;
    for (int i = 0; i < 16; ++i) { const int t = tq * 16 + i; float z = bg;
#pragma unroll
        for (int j = 0; j < 16; ++j) z += GLt[t * 16 + j] * wr[j];
        const float gk = (fminf(z, 0.f) - log1pf(expf(-fabsf(z)))) * (1.0f / 16.0f);
        run += gk; B[t * 128 + d] = run; }
    TOT[tq * 128 + d] = run;
    __syncthreads();
    float off = 0.f;
    for (int q = 0; q < tq; ++q) off += TOT[q * 128 + d];
    if (tq > 0) for (int i = 0; i < 16; ++i) B[(tq * 16 + i) * 128 + d] += off;
    __syncthreads();
}
__device__ __forceinline__ bf16* gla_state_ptr(Frame& F, int item) {
    return item < NITEM / 2 ? (bf16*)(F.ws + WS_GV) + (size_t)item * (GDV * GDK) : (bf16*)F.out + (size_t)(item - NITEM / 2) * (GDV * GDK);
}
__device__ __forceinline__ void gla_state_phase(Frame& F) {
    const int tid = F.tid, lane = F.lane, w = F.wave;
    LAS float* B = (LAS float*)(F.lds + GL_B); LAS unsigned char* Xl = F.lds + GL_X; LAS unsigned char* Vl = F.lds + GL_V;
    const bf16* Kg = (const bf16*)(F.ws + WS_K); const bf16* YAB = (const bf16*)(F.ws + WS_YAB); float* decay = (float*)(F.ws + WS_DECAY);
    for (int item = F.vcu; item < NITEM; item += F.G) {
        const int n = item & 63, bh = item >> 6, h = bh & 3, b = bh >> 2, T0 = b * SEQ + n * GCH;
        gla_cumdecay(F, T0, h);
        if (tid < 128) decay[(size_t)item * 128 + tid] = expf(B[63 * 128 + tid]);
        { const int s = tid >> 3, dq = tid & 7; const v4u* kp = (const v4u*)(Kg + (size_t)(T0 + s) * 512 + h * 128 + dq * 16);
#pragma unroll
          for (int i = 0; i < 2; ++i) { float f[8]; unpack8(kp[i], f);
#pragma unroll
              for (int e = 0; e < 8; ++e) { const int dd = dq * 16 + 8 * i + e; f[e] *= expf(B[63 * 128 + dd] - B[s * 128 + dd]); }
              *(LAS v4u*)(Xl + s * XST + (dq * 16 + 8 * i) * 2) = pack8(f); }
          const v4u* vp = (const v4u*)(YAB + (size_t)(T0 + s) * 2048 + 1024 + h * 256 + dq * 32);
#pragma unroll
          for (int i = 0; i < 4; ++i) *(LAS v4u*)(Vl + s * VSTG + (dq * 32 + 8 * i) * 2) = vp[i]; }
        __syncthreads();
        f32x4 acc[2][8];
#pragma unroll
        for (int vi = 0; vi < 2; ++vi)
#pragma unroll
            for (int dt = 0; dt < 8; ++dt) acc[vi][dt] = (f32x4){0.f, 0.f, 0.f, 0.f};
#pragma unroll
        for (int ks = 0; ks < 2; ++ks) {
            bf16x8 vf[2]; vf[0] = frag_tr(Vl, VSTG, 32 * ks, 32 * w, lane); vf[1] = frag_tr(Vl, VSTG, 32 * ks, 32 * w + 16, lane);
#pragma unroll
            for (int dt = 0; dt < 8; ++dt) { const bf16x8 kf = frag_tr(Xl, XST, 32 * ks, 16 * dt, lane);
                acc[0][dt] = MFMA16(kf, vf[0], acc[0][dt]); acc[1][dt] = MFMA16(kf, vf[1], acc[1][dt]); }
        }
        bf16* ST = gla_state_ptr(F, item);
#pragma unroll
        for (int vi = 0; vi < 2; ++vi) { bf16* sp = ST + (size_t)(32 * w + 16 * vi + (lane & 15)) * GDK + 4 * (lane >> 4);
#pragma unroll
            for (int dt = 0; dt < 8; ++dt) { v2u o; o.x = pk2(acc[vi][dt][0], acc[vi][dt][1]); o.y = pk2(acc[vi][dt][2], acc[vi][dt][3]); *(v2u*)(sp + 16 * dt) = o; } }
        __syncthreads();
    }
}
__device__ __forceinline__ void gla_scan_phase(Frame& F) {
    const float* decay = (const float*)(F.ws + WS_DECAY);
    for (int gt = blockIdx.x * 512 + F.tid; gt < BATCH * GH * GDV * (GDK / 4); gt += F.G * 512) {
        const int bh = gt >> 13, rem = gt & 8191, v = rem >> 5, d0 = (rem & 31) * 4;
        float S[4] = {0.f, 0.f, 0.f, 0.f};
        for (int n0 = 0; n0 < NCH; n0 += 8) {
            v2u kv[8]; f32x4 dc[8];
#pragma unroll
            for (int i = 0; i < 8; ++i) { const int item = bh * 64 + n0 + i; kv[i] = *(const v2u*)(gla_state_ptr(F, item) + v * GDK + d0); dc[i] = *(const f32x4*)(decay + (size_t)item * 128 + d0); }
#pragma unroll
            for (int i = 0; i < 8; ++i) { const int item = bh * 64 + n0 + i; v2u o; o.x = pk2(S[0], S[1]); o.y = pk2(S[2], S[3]); *(v2u*)(gla_state_ptr(F, item) + v * GDK + d0) = o;
                S[0] = dc[i][0] * S[0] + bflo(kv[i].x); S[1] = dc[i][1] * S[1] + bfhi(kv[i].x); S[2] = dc[i][2] * S[2] + bflo(kv[i].y); S[3] = dc[i][3] * S[3] + bfhi(kv[i].y); }
        }
    }
}
__device__ __forceinline__ void gla_out_phase(Frame& F) {
    const int tid = F.tid, lane = F.lane, w = F.wave;
    LAS float* B = (LAS float*)(F.lds + GL_B); LAS unsigned char* Xl = F.lds + GL_X; LAS unsigned char* Yl = F.lds + GL_Y; LAS unsigned char* Vl = F.lds + GL_V; LAS unsigned char* Pl = F.lds + GL_P;
    LAS float* RS = (LAS float*)(F.lds + GL_RS);
    const bf16* Qg = (const bf16*)(F.ws + WS_Q); const bf16* Kg = (const bf16*)(F.ws + WS_K); bf16* YAB = (bf16*)(F.ws + WS_YAB); const bf16* Rg = (const bf16*)(F.ws + WS_R);
    const float* gnw = F.in[10];
    for (int item = F.vcu; item < NITEM; item += F.G) {
        const int n = item & 63, bh = item >> 6, h = bh & 3, b = bh >> 2, T0 = b * SEQ + n * GCH;
        gla_cumdecay(F, T0, h);
        const bf16* ST = gla_state_ptr(F, item);
        bf16x8 sf[2][4];
#pragma unroll
        for (int vi = 0; vi < 2; ++vi)
#pragma unroll
            for (int ks = 0; ks < 4; ++ks) sf[vi][ks] = *(const bf16x8*)(ST + (size_t)(32 * w + 16 * vi + (lane & 15)) * GDK + 32 * ks + 8 * (lane >> 4));
        { const int s = tid >> 3, dq = tid & 7; const v4u* qp = (const v4u*)(Qg + (size_t)(T0 + s) * 512 + h * 128 + dq * 16); const v4u* kp = (const v4u*)(Kg + (size_t)(T0 + s) * 512 + h * 128 + dq * 16);
#pragma unroll
          for (int i = 0; i < 2; ++i) { float fq_[8], fk[8]; unpack8(qp[i], fq_); unpack8(kp[i], fk);
#pragma unroll
              for (int e = 0; e < 8; ++e) { const float bb = B[s * 128 + dq * 16 + 8 * i + e]; fq_[e] *= expf(bb); fk[e] *= expf(-bb); }
              *(LAS v4u*)(Xl + s * XST + (dq * 16 + 8 * i) * 2) = pack8(fq_); *(LAS v4u*)(Yl + s * XST + (dq * 16 + 8 * i) * 2) = pack8(fk); }
          const v4u* vp = (const v4u*)(YAB + (size_t)(T0 + s) * 2048 + 1024 + h * 256 + dq * 32);
#pragma unroll
          for (int i = 0; i < 4; ++i) *(LAS v4u*)(Vl + s * VSTG + (dq * 32 + 8 * i) * 2) = vp[i]; }
        __syncthreads();
        for (int tile = w; tile < 16; tile += 8) { const int ti = tile >> 2, si = tile & 3; f32x4 a = {0.f, 0.f, 0.f, 0.f};
            if (si <= ti) {
#pragma unroll
                for (int ks = 0; ks < 4; ++ks) { const bf16x8 kf = frag_nat(Yl, XST, 16 * si, 32 * ks, lane), qf = frag_nat(Xl, XST, 16 * ti, 32 * ks, lane); a = MFMA16(kf, qf, a); } }
            const int t = 16 * ti + (lane & 15), s0 = 16 * si + 4 * (lane >> 4);
#pragma unroll
            for (int r = 0; r < 4; ++r) if (s0 + r > t) a[r] = 0.f;
            v2u o; o.x = pk2(a[0], a[1]); o.y = pk2(a[2], a[3]); *(LAS v2u*)(Pl + t * PST + s0 * 2) = o; }
        __syncthreads();
        f32x4 acc[4][2];
#pragma unroll
        for (int ti = 0; ti < 4; ++ti) { acc[ti][0] = (f32x4){0.f, 0.f, 0.f, 0.f}; acc[ti][1] = (f32x4){0.f, 0.f, 0.f, 0.f}; }
#pragma unroll
        for (int ks = 0; ks < 4; ++ks) {
#pragma unroll
            for (int ti = 0; ti < 4; ++ti) { const bf16x8 qf = frag_nat(Xl, XST, 16 * ti, 32 * ks, lane); acc[ti][0] = MFMA16(sf[0][ks], qf, acc[ti][0]); acc[ti][1] = MFMA16(sf[1][ks], qf, acc[ti][1]); } }
#pragma unroll
        for (int ks = 0; ks < 2; ++ks) { bf16x8 vf[2]; vf[0] = frag_tr(Vl, VSTG, 32 * ks, 32 * w, lane); vf[1] = frag_tr(Vl, VSTG, 32 * ks, 32 * w + 16, lane);
#pragma unroll
            for (int ti = 0; ti < 4; ++ti) if (32 * ks <= 16 * ti + 15) { const bf16x8 pf = frag_nat(Pl, PST, 16 * ti, 32 * ks, lane); acc[ti][0] = MFMA16(vf[0], pf, acc[ti][0]); acc[ti][1] = MFMA16(vf[1], pf, acc[ti][1]); } }
#pragma unroll
        for (int ti = 0; ti < 4; ++ti) { float ss = 0.f;
#pragma unroll
            for (int vi = 0; vi < 2; ++vi)
#pragma unroll
                for (int r = 0; r < 4; ++r) ss += acc[ti][vi][r] * acc[ti][vi][r];
            ss += __shfl_xor(ss, 16); ss += __shfl_xor(ss, 32);
            if (lane < 16) RS[(16 * ti + lane) * 8 + w] = ss; }
        __syncthreads();
#pragma unroll
        for (int ti = 0; ti < 4; ++ti) { const int t = 16 * ti + (lane & 15); float tot = 0.f;
#pragma unroll
            for (int q = 0; q < 8; ++q) tot += RS[t * 8 + q];
            const float rinv = 1.0f / sqrtf(tot * (1.0f / GDV) + EPS);
#pragma unroll
            for (int vi = 0; vi < 2; ++vi) { const int v = 32 * w + 16 * vi + 4 * (lane >> 4); const f32x4 gw4 = *(const f32x4*)(gnw + v);
                const v2u rr = *(const v2u*)(Rg + (size_t)(T0 + t) * D + h * 256 + v);
                v2u o; o.x = pk2(acc[ti][vi][0] * rinv * gw4[0] * bflo(rr.x), acc[ti][vi][1] * rinv * gw4[1] * bfhi(rr.x)); o.y = pk2(acc[ti][vi][2] * rinv * gw4[2] * bflo(rr.y), acc[ti][vi][3] * rinv * gw4[3] * bfhi(rr.y));
                *(v2u*)(YAB + (size_t)(T0 + t) * 2048 + 1024 + h * 256 + v) = o; } }
        __syncthreads();
    }
}
__device__ __forceinline__ void final_norm_phase(Frame& F) {
    const int gw = F.vcu * NWAVES + F.wave, NGW = F.G * NWAVES; const float* fw = F.in[18]; const float* rsq = (const float*)(F.ws + WS_RSQ2);
    f32x4 wv[4];
#pragma unroll
    for (int j = 0; j < 4; ++j) wv[j] = *((const f32x4*)fw + F.lane + 64 * j);
    for (int m = gw; m < M; m += NGW) { const float rs = 1.0f / sqrtf(rsq[m] * (1.f / D) + EPS); GAS f32x4* p = (GAS f32x4*)(F.out + (size_t)m * D) + F.lane;
#pragma unroll
        for (int j = 0; j < 4; ++j) p[64 * j] = p[64 * j] * rs * wv[j]; }
}

struct Args { const float* in[19]; float* out; unsigned char* ws; int ph_lo, ph_hi; };
__global__ void __launch_bounds__(NWAVES * 64, 2) mk_fwd(Args args) {
    extern __shared__ __attribute__((aligned(16))) unsigned char lds[];
    Frame F;
    F.lds = (LAS unsigned char*)lds;
    F.tid = threadIdx.x; F.lane = F.tid & 63; F.wave = __builtin_amdgcn_readfirstlane(F.tid >> 6);
    F.G = gridDim.x; { const int bx = blockIdx.x; F.vcu = (F.G % 8 == 0) ? (bx % 8) * (F.G / 8) + bx / 8 : bx; }
#pragma unroll
    for (int i = 0; i < 19; ++i) F.in[i] = args.in[i];
    F.out = args.out; F.ws = args.ws;
    for (int u = F.tid; u < (LDS_BYTES - LDSCTL_OFF) / 4; u += NWAVES * 64) ((LAS unsigned*)(F.lds + LDSCTL_OFF))[u] = 0u;
    __syncthreads();
    XcdBarrier bar = xcd_barrier_post((unsigned*)(F.ws + WS_CTL) + 4096, (volatile LAS unsigned*)(F.lds + MISC_OFF) + 8);
    const int lo = args.ph_lo, hi = args.ph_hi;
#define IN(k) (lo <= (k) && (k) < hi)
#define SEAM(k) do { if (IN(k) && IN((k) + 1)) xcd_barrier(bar); } while (0)
    bf16* XN = (bf16*)F.out;
    if (IN(0)) { p0_prologue(F); } SEAM(0);
    if (IN(1)) {
        pg8::Gemm g{XN, (const bf16*)(F.ws + WS_WIN), M, NPROJ, D, D, D, 0, 0}; pg8::StaticOrder S; S.init(M, NPROJ, F.G, (int)blockIdx.x);
        pg8::EpiInProj E{(bf16*)(F.ws + WS_YAB), (bf16*)(F.ws + WS_GV), (bf16*)(F.ws + WS_Q), (bf16*)(F.ws + WS_K), (bf16*)(F.ws + WS_R), (bf16*)(F.ws + WS_GA), (bf16*)F.out + (size_t)M * D, F.in[3]};
        pg8::gemm_phase<pg8::EpiInProj, pg8::StaticOrder, true>(F.lds, g, S, E);
        glr_phase(F);
    } SEAM(1);
    if (IN(2)) { sgu_phase(F); } SEAM(2);
    if (IN(3)) { gla_state_phase(F); } SEAM(3);
    if (IN(4)) { gla_scan_phase(F); } SEAM(4);
    if (IN(5)) { gla_out_phase(F); } SEAM(5);
    if (IN(6)) {
        pg8::Gemm g{(const bf16*)(F.ws + WS_YAB), (const bf16*)(F.ws + WS_WAB), M, D, D, 2048, D, (size_t)D * 2, (size_t)D * D * 2}; pg8::StaticOrder S; S.init(M, D, F.G, (int)blockIdx.x, 2);
        pg8::EpiBranch E{(bf16*)(F.ws + WS_GV), (const bf16*)(F.ws + WS_GA), (const bf16*)F.out + (size_t)M * D};
        pg8::gemm_phase<pg8::EpiBranch, pg8::StaticOrder, true>(F.lds, g, S, E);
    } SEAM(6);
    if (IN(7)) {
        pg8::Gemm g{(const bf16*)(F.ws + WS_GV), (const bf16*)(F.ws + WS_WOUT), M, D, D, D, D, 0, 0}; pg8::StaticOrder S; S.init(M, D, F.G, (int)blockIdx.x);
        pg8::EpiResid E{F.in[0], F.out, (bf16*)(F.ws + WS_YAB), (float*)(F.ws + WS_RSQ1)};
        pg8::gemm_phase<pg8::EpiResid, pg8::StaticOrder, true>(F.lds, g, S, E);
    } SEAM(7);
    if (IN(8)) {
        pg8::Gemm g{(const bf16*)(F.ws + WS_YAB), (const bf16*)(F.ws + WS_WGU), M, NGU, D, D, D, 0, 0}; pg8::StaticOrder S; S.init(M, NGU, F.G, (int)blockIdx.x);
        pg8::EpiSwiGLU E{(bf16*)(F.ws + WS_ACT), (const float*)(F.ws + WS_RSQ1)};
        pg8::gemm_phase<pg8::EpiSwiGLU, pg8::StaticOrder, true>(F.lds, g, S, E);
    } SEAM(8);
    if (IN(9)) {
        pg8::Gemm g{(const bf16*)(F.ws + WS_ACT), (const bf16*)(F.ws + WS_WDN), M, D, DFF, DFF, DFF, 0, 0}; pg8::StaticOrder S; S.init(M, D, F.G, (int)blockIdx.x);
        pg8::EpiResid E{F.out, F.out, nullptr, (float*)(F.ws + WS_RSQ2)};
        pg8::gemm_phase<pg8::EpiResid, pg8::StaticOrder, true>(F.lds, g, S, E);
    } SEAM(9);
    if (IN(10)) { final_norm_phase(F); }
#undef IN
#undef SEAM
}

extern "C" void kernel_launch(void* const* d_in, const int* in_sizes, int n_in, void* d_out, int out_size, void* d_ws, size_t ws_size, hipStream_t stream) {
    static int grid = 0;
    if (grid == 0) {
        if (n_in != 19 || in_sizes[0] != M * D || out_size != M * D || ws_size < WS_END) { fprintf(stderr, "kernel_launch: unexpected shapes (n_in %d, in0 %d, out %d, ws %zu)\n", n_in, n_in > 0 ? in_sizes[0] : -1, out_size, ws_size); grid = -1; return; }
        int dev = 0, cus = 0;
        if (hipGetDevice(&dev) != hipSuccess || hipDeviceGetAttribute(&cus, hipDeviceAttributeMultiprocessorCount, dev) != hipSuccess) { grid = -1; return; }
        if (hipFuncSetAttribute((const void*)mk_fwd, hipFuncAttributeMaxDynamicSharedMemorySize, LDS_BYTES) != hipSuccess) { fprintf(stderr, "kernel_launch: hipFuncSetAttribute failed\n"); grid = -1; return; }
        (void)hipGetLastError();
        grid = cus;
    }
    if (grid < 0) return;
    (void)hipMemsetAsync((char*)d_ws + WS_CTL, 0, CTL_ZERO_BYTES, stream);
    Args a{};
    for (int i = 0; i < 19; ++i) a.in[i] = (const float*)d_in[i];
    a.out = (float*)d_out; a.ws = (unsigned char*)d_ws; a.ph_lo = 0; a.ph_hi = 11;
    hipLaunchKernelGGL(mk_fwd, dim3(grid), dim3(NWAVES * 64), LDS_BYTES, stream, a);
}
```
